# Optimizing an MI355X kernel written in HIP

```python
import jax, jax.numpy as jnp
from jax import lax
import numpy as np

D_MODEL = 1024
BATCH = 16
SEQ = 256
DEPTH = 4
DEC_BATCH = 4
DEC_SEQ = 1024
PAST_LEN = 256

GRID_W = 64
HEAD_DIM = 64
CHUNK = 128
A_WIDTH = D_MODEL // 2
A_GROUPS = 4
A_GROUP_CH = A_WIDTH // A_GROUPS
B_HEADS = (D_MODEL // 2) // HEAD_DIM
B_KV_HEADS = B_HEADS // 4
C_HEADS = D_MODEL // HEAD_DIM
NA_MAX_ROWS = 8
NA_COLS = 16
D_FF = ((8 * D_MODEL // 3 + 255) // 256) * 256
ROPE_BASE = 10000.0
EPS = 1e-6
Q_BLOCK = 128
N_EVEN = (DEPTH + 1) // 2
N_ODD = DEPTH // 2
EVEN_SPLITS = (A_WIDTH, 2 * A_WIDTH, 2 * A_WIDTH + B_HEADS * HEAD_DIM, 2 * A_WIDTH + (B_HEADS + B_KV_HEADS) * HEAD_DIM)
EVEN_IN = 2 * A_WIDTH + (B_HEADS + 2 * B_KV_HEADS) * HEAD_DIM
ODD_IN = 3 * C_HEADS * HEAD_DIM
NEG = -1e30

kernel_name = 'hybrid_gmlp_gqa_natten_prefix_dit_step'


def rms_norm(x, g):
    xf = x.astype(jnp.float32)
    y = xf * lax.rsqrt(jnp.mean(xf * xf, axis=-1, keepdims=True) + EPS)
    return (y * g.astype(jnp.float32)).astype(x.dtype)


def layer_norm(x, g):
    xf = x.astype(jnp.float32)
    mu = jnp.mean(xf, axis=-1, keepdims=True)
    var = jnp.mean(jnp.square(xf - mu), axis=-1, keepdims=True)
    return ((xf - mu) * lax.rsqrt(var + EPS) * g.astype(jnp.float32)).astype(x.dtype)


def modulation(cond, w_mod, b_mod):
    m = jax.nn.silu(cond) @ w_mod + b_mod
    return jnp.split(m[:, None, :], 6, axis=-1)


def sublayer_in(x, g, shift, scale):
    return rms_norm(x, g) * (1 + scale) + shift


def sublayer_out(x, y, g, gate):
    return x + gate * rms_norm(y, g)


def axial_rope(x):
    s = x.shape[1]
    t = jnp.arange(s)
    half = HEAD_DIM // 2
    nf = half // 2
    freqs = ROPE_BASE ** (-jnp.arange(nf, dtype=jnp.float32) / nf)

    def rot(xa, pos):
        ang = pos.astype(jnp.float32)[:, None] * freqs[None, :]
        cos = jnp.cos(ang)[None, :, None, :]
        sin = jnp.sin(ang)[None, :, None, :]
        x1 = xa[..., :nf].astype(jnp.float32)
        x2 = xa[..., nf:].astype(jnp.float32)
        return jnp.concatenate([x1 * cos - x2 * sin, x2 * cos + x1 * sin], axis=-1)

    out = jnp.concatenate([rot(x[..., :half], t // GRID_W), rot(x[..., half:], t % GRID_W)], axis=-1)
    return out.astype(x.dtype)


def blocked_attention(q, k, v):
    b, sq, h, d = q.shape
    hk = k.shape[2]
    g = h // hk
    nb = sq // Q_BLOCK
    scale = d ** -0.5
    qb = q.reshape(b, nb, Q_BLOCK, hk, g, d).transpose(1, 0, 2, 3, 4, 5)

    def one_block(qblk):
        s = jnp.einsum('bqngd,bsnd->bngqs', qblk, k).astype(jnp.float32) * scale
        p = jax.nn.softmax(s, axis=-1).astype(v.dtype)
        return jnp.einsum('bngqs,bsnd->bqngd', p, v)

    o = lax.map(one_block, qb)
    return o.transpose(1, 0, 2, 3, 4, 5).reshape(b, sq, h, d)


def chunk_gmlp(u, v, sgu_w, sgu_b, sgu_norm):
    b, s, _ = u.shape
    n = s // CHUNK
    u = jax.nn.gelu(u)
    v = layer_norm(jax.nn.gelu(v), sgu_norm)
    vc = v.reshape(b, n, CHUNK, A_GROUPS, A_GROUP_CH)
    mixed = jnp.einsum('gpq,bnqgc->bnpgc', sgu_w, vc) + sgu_b.T[None, None, :, :, None]
    return u * mixed.reshape(b, s, A_WIDTH)


def even_mixer(h, w_in, w_out, sgu_w, sgu_b, sgu_norm, q_norm, k_norm, ctx_k=None, ctx_v=None):
    b, s, _ = h.shape
    z = h @ w_in
    u, v, q, k, vals = jnp.split(z, EVEN_SPLITS, axis=-1)
    a_out = chunk_gmlp(u, v, sgu_w, sgu_b, sgu_norm)
    q = rms_norm(q.reshape(b, s, B_HEADS, HEAD_DIM), q_norm)
    k = rms_norm(k.reshape(b, s, B_KV_HEADS, HEAD_DIM), k_norm)
    vals = vals.reshape(b, s, B_KV_HEADS, HEAD_DIM)
    if ctx_k is None:
        b_out = blocked_attention(q, k, vals)
    else:
        keys = jnp.concatenate([axial_rope(k), ctx_k.astype(k.dtype)], axis=1)
        values = jnp.concatenate([vals, ctx_v.astype(vals.dtype)], axis=1)
        b_out = blocked_attention(axial_rope(q), keys, values)
    y = jnp.concatenate([a_out, b_out.reshape(b, s, B_HEADS * HEAD_DIM)], axis=-1) @ w_out
    return y, k, vals


def neighbourhood_attention(q, k, v, ctx_k, ctx_v, rpb):
    b, s, h, d = q.shape
    rows = s // GRID_W
    wr = min(NA_MAX_ROWS, rows)
    scale = d ** -0.5
    qg = q.reshape(b, rows, GRID_W, h, d)
    kg = k.reshape(b, rows, GRID_W, h, d)
    vg = v.reshape(b, rows, GRID_W, h, d)
    cols = jnp.arange(GRID_W)
    col_start = jnp.clip(cols - NA_COLS // 2, 0, GRID_W - NA_COLS)
    col_in = (cols[None, :] >= col_start[:, None]) & (cols[None, :] < col_start[:, None] + NA_COLS)
    col_idx = jnp.clip(cols[None, :] - cols[:, None] + NA_COLS - 1, 0, 2 * NA_COLS - 2)
    rpb = rpb.astype(jnp.float32)

    def one_row(r):
        rs = jnp.clip(r - wr // 2, 0, rows - wr)
        qr = lax.dynamic_index_in_dim(qg, r, axis=1, keepdims=False)
        kb = lax.dynamic_slice_in_dim(kg, rs, wr, axis=1)
        vb = lax.dynamic_slice_in_dim(vg, rs, wr, axis=1)
        s_win = jnp.einsum('bqhd,brwhd->bhqrw', qr, kb).astype(jnp.float32) * scale
        row_idx = rs + jnp.arange(wr) - r + NA_MAX_ROWS - 1
        bias = rpb[:, row_idx][:, :, col_idx].transpose(0, 2, 1, 3)
        s_win = jnp.where(col_in[None, None, :, None, :], s_win + bias[None], NEG)
        s_ctx = jnp.einsum('bqhd,bchd->bhqc', qr, ctx_k).astype(jnp.float32) * scale
        scores = jnp.concatenate([s_win.reshape(b, h, GRID_W, wr * GRID_W), s_ctx], axis=-1)
        p = jax.nn.softmax(scores, axis=-1).astype(v.dtype)
        p_win = p[..., :wr * GRID_W].reshape(b, h, GRID_W, wr, GRID_W)
        p_ctx = p[..., wr * GRID_W:]
        return jnp.einsum('bhqrw,brwhd->bqhd', p_win, vb) + jnp.einsum('bhqc,bchd->bqhd', p_ctx, ctx_v)

    o = lax.map(one_row, jnp.arange(rows))
    return o.transpose(1, 0, 2, 3, 4).reshape(b, s, h, d)


def odd_mixer(h, w_in, w_out, rpb, ctx_k=None, ctx_v=None):
    b, s, _ = h.shape
    q, k, v = jnp.split(h @ w_in, 3, axis=-1)
    q = q.reshape(b, s, C_HEADS, HEAD_DIM)
    k = k.reshape(b, s, C_HEADS, HEAD_DIM)
    v = v.reshape(b, s, C_HEADS, HEAD_DIM)
    if ctx_k is None:
        o = blocked_attention(q, k, v)
    else:
        o = neighbourhood_attention(q, k, v, ctx_k.astype(k.dtype), ctx_v.astype(v.dtype), rpb)
    return o.reshape(b, s, C_HEADS * HEAD_DIM) @ w_out, k, v


def swiglu(h, w_in, w_out):
    g, u = jnp.split(h @ w_in, 2, axis=-1)
    return (jax.nn.silu(g) * u) @ w_out


def setup_inputs(seed: int = 0) -> dict:
    key = jax.random.key(seed)
    ks = iter(jax.random.split(key, 32))

    def nrm(shape, scale):
        return jax.random.normal(next(ks), shape, jnp.float32) * scale

    def gain(shape):
        return 1.0 + nrm(shape, 0.01)

    d = D_MODEL
    return {
        'x_prompt': nrm((BATCH, SEQ, d), 1.0),
        'x_sample': nrm((DEC_BATCH, DEC_SEQ, d), 1.0),
        'cache_attn_k': nrm((DEC_BATCH, N_EVEN, PAST_LEN, B_KV_HEADS, HEAD_DIM), 1.0),
        'cache_attn_v': nrm((DEC_BATCH, N_EVEN, PAST_LEN, B_KV_HEADS, HEAD_DIM), 1.0),
        'cache_na_k': nrm((DEC_BATCH, N_ODD, PAST_LEN, C_HEADS, HEAD_DIM), 1.0),
        'cache_na_v': nrm((DEC_BATCH, N_ODD, PAST_LEN, C_HEADS, HEAD_DIM), 1.0),
        'c': nrm((DEC_BATCH, d), 1.0),
        'c_ctx': nrm((d,), 1.0),
        'mod_w': nrm((DEPTH, d, 6 * d), 0.5 * d ** -0.5),
        'mod_b': nrm((DEPTH, 6 * d), 0.01),
        'norm_mix_pre': gain((DEPTH, d)),
        'norm_mix_post': gain((DEPTH, d)),
        'norm_ffn_pre': gain((DEPTH, d)),
        'norm_ffn_post': gain((DEPTH, d)),
        'even_w_in': nrm((N_EVEN, d, EVEN_IN), d ** -0.5),
        'even_w_out': nrm((N_EVEN, d, d), d ** -0.5),
        'sgu_w': nrm((N_EVEN, A_GROUPS, CHUNK, CHUNK), CHUNK ** -0.5),
        'sgu_b': gain((N_EVEN, A_GROUPS, CHUNK)),
        'sgu_norm': gain((N_EVEN, A_WIDTH)),
        'q_norm': gain((N_EVEN, HEAD_DIM)),
        'k_norm': gain((N_EVEN, HEAD_DIM)),
        'odd_w_in': nrm((N_ODD, d, ODD_IN), d ** -0.5),
        'odd_w_out': nrm((N_ODD, d, d), d ** -0.5),
        'na_rpb': nrm((N_ODD, C_HEADS, 2 * NA_MAX_ROWS - 1, 2 * NA_COLS - 1), 0.02),
        'ffn_w_in': nrm((DEPTH, d, 2 * D_FF), d ** -0.5),
        'ffn_w_out': nrm((DEPTH, D_FF, d), D_FF ** -0.5),
    }


def reference(x_prompt, x_sample, cache_attn_k, cache_attn_v, cache_na_k, cache_na_v, c, c_ctx,
              mod_w, mod_b, norm_mix_pre, norm_mix_post, norm_ffn_pre, norm_ffn_post,
              even_w_in, even_w_out, sgu_w, sgu_b, sgu_norm, q_norm, k_norm,
              odd_w_in, odd_w_out, na_rpb, ffn_w_in, ffn_w_out):
    xp, xs = x_prompt, x_sample
    attn_k, attn_v, na_k, na_v = [], [], [], []
    for l in range(DEPTH):
        sh_p, sc_p, gt_p, fsh_p, fsc_p, fgt_p = modulation(c_ctx[None, :], mod_w[l], mod_b[l])
        sh_s, sc_s, gt_s, fsh_s, fsc_s, fgt_s = modulation(c, mod_w[l], mod_b[l])
        hp = sublayer_in(xp, norm_mix_pre[l], sh_p, sc_p)
        hs = sublayer_in(xs, norm_mix_pre[l], sh_s, sc_s)
        if l % 2 == 0:
            e = l // 2
            yp, kp, vp = even_mixer(hp, even_w_in[e], even_w_out[e], sgu_w[e], sgu_b[e], sgu_norm[e], q_norm[e], k_norm[e])
            ys, _, _ = even_mixer(hs, even_w_in[e], even_w_out[e], sgu_w[e], sgu_b[e], sgu_norm[e], q_norm[e], k_norm[e],
                                  ctx_k=cache_attn_k[:, e], ctx_v=cache_attn_v[:, e])
            attn_k.append(kp)
            attn_v.append(vp)
        else:
            o = l // 2
            yp, kp, vp = odd_mixer(hp, odd_w_in[o], odd_w_out[o], na_rpb[o])
            ys, _, _ = odd_mixer(hs, odd_w_in[o], odd_w_out[o], na_rpb[o], ctx_k=cache_na_k[:, o], ctx_v=cache_na_v[:, o])
            na_k.append(kp)
            na_v.append(vp)
        xp = sublayer_out(xp, yp, norm_mix_post[l], gt_p)
        xs = sublayer_out(xs, ys, norm_mix_post[l], gt_s)
        fp = swiglu(sublayer_in(xp, norm_ffn_pre[l], fsh_p, fsc_p), ffn_w_in[l], ffn_w_out[l])
        fs = swiglu(sublayer_in(xs, norm_ffn_pre[l], fsh_s, fsc_s), ffn_w_in[l], ffn_w_out[l])
        xp = sublayer_out(xp, fp, norm_ffn_post[l], fgt_p)
        xs = sublayer_out(xs, fs, norm_ffn_post[l], fgt_s)
    new_attn_k = jnp.stack(attn_k, axis=1)
    new_attn_v = jnp.stack(attn_v, axis=1)
    new_na_k = jnp.stack(na_k, axis=1)
    new_na_v = jnp.stack(na_v, axis=1)
    return (xp, xs, new_attn_k, new_attn_v, new_na_k, new_na_v)
```

```cpp
#include <hip/hip_runtime.h>
#include <cstdio>
#include <cstdint>

#ifndef MK_PER_PHASE
#define MK_PER_PHASE 1
#endif

#define LAS __attribute__((address_space(3)))
#define GAS __attribute__((address_space(1)))
typedef unsigned short bf16_t;
typedef short bf16x8 __attribute__((ext_vector_type(8)));
typedef short s16x4 __attribute__((ext_vector_type(4)));
typedef float f32x2 __attribute__((ext_vector_type(2)));
typedef float f32x4 __attribute__((ext_vector_type(4)));
typedef float f32x16 __attribute__((ext_vector_type(16)));
typedef unsigned u32x2 __attribute__((ext_vector_type(2)));
typedef unsigned u32x4 __attribute__((ext_vector_type(4)));
typedef __bf16 bf16x2_t __attribute__((ext_vector_type(2)));

constexpr int DM = 1024, NTOK = 8192, NPR = 4096, DFF = 2816, EVEN_IN = 1792, ODD_IN = 3072, DEPTH = 4;
constexpr float EPS = 1e-6f;
constexpr float LOG2E = 1.4426950408889634f;
constexpr float C2 = 0.125f * LOG2E;

constexpr size_t OUT_X = 0;
constexpr size_t OUT_AK = (size_t)NTOK * DM;
constexpr size_t OUT_AV = OUT_AK + 1048576;
constexpr size_t OUT_NK = OUT_AV + 1048576;
constexpr size_t OUT_NV = OUT_NK + 8388608;

constexpr size_t MiB = 1u << 20;
constexpr size_t WS_CTL = 0, CTL_ZERO_BYTES = 64 * 1024;
constexpr size_t WS_MOD = 1 * MiB;
constexpr size_t WS_ROPE = WS_MOD + 512 * 1024;
constexpr size_t WS_SGUW = WS_MOD + 768 * 1024;
constexpr size_t WS_WINE = 2 * MiB;
constexpr size_t WS_WOUTE = WS_WINE + 7 * MiB;
constexpr size_t WS_WINO = WS_WOUTE + 4 * MiB;
constexpr size_t WS_WOUTO = WS_WINO + 12 * MiB;
constexpr size_t WS_WFI = WS_WOUTO + 4 * MiB;
constexpr size_t WS_WFO = WS_WFI + 44 * MiB;
constexpr size_t WS_H = 96 * MiB;
constexpr size_t WS_Z = 112 * MiB;
constexpr size_t WS_UG = 160 * MiB;
constexpr size_t WS_VN = 168 * MiB;
constexpr size_t WS_QB = 176 * MiB;
constexpr size_t WS_KP = 184 * MiB;
constexpr size_t WS_VP = 185 * MiB;
constexpr size_t WS_KS = 186 * MiB;
constexpr size_t WS_VS = 189 * MiB;
constexpr size_t WS_CK = 192 * MiB;
constexpr size_t WS_CV = 196 * MiB;
constexpr size_t WS_AO = 200 * MiB;
constexpr size_t WS_ACT = 216 * MiB;
constexpr size_t WS_Y0 = 260 * MiB;
constexpr size_t WS_END = 324 * MiB;
static_assert(WS_WFO + 22 * MiB <= WS_H, "ws map");

__device__ __forceinline__ unsigned cvtpk(float lo, float hi) { f32x2 v = {lo, hi}; bf16x2_t b = __builtin_convertvector(v, bf16x2_t); return __builtin_bit_cast(unsigned, b); }
__device__ __forceinline__ float bf2f(unsigned short h) { return __builtin_bit_cast(float, (unsigned)h << 16); }
__device__ __forceinline__ float bflo(unsigned w) { return __builtin_bit_cast(float, w << 16); }
__device__ __forceinline__ float bfhi(unsigned w) { return __builtin_bit_cast(float, w & 0xffff0000u); }
__device__ __forceinline__ float wave_sum(float v) {
#pragma unroll
    for (int o = 1; o < 64; o <<= 1) v += __shfl_xor(v, o);
    return v;
}
__device__ __forceinline__ float fast_exp2(float x) { return __builtin_amdgcn_exp2f(x); }
__device__ __forceinline__ float fast_rcp(float x) { return __builtin_amdgcn_rcpf(x); }
__device__ __forceinline__ float gelu_tanh(float x) {
    const float a = 1.5957691216057308f * (x + 0.044715f * x * x * x);
    return x * fast_rcp(1.0f + fast_exp2(-a * LOG2E));
}
__device__ __forceinline__ float silu_f(float x) { return x * fast_rcp(1.0f + fast_exp2(-x * LOG2E)); }

namespace pg8 {
constexpr int BM = 256, BK = 64, HALF = 128, HTB = HALF * BK * 2, STAGE_BYTES = 8 * HTB, NXCD = 8, WGM = 8;
__host__ __device__ __forceinline__ int lds_byte(int r, int c) { const int st = (r >> 4) * 2 + (c >> 5), rr = r & 15, cc = c & 31, ob = rr * 64 + cc * 2; return st * 1024 + (ob ^ (((ob >> 9) & 1) << 5)); }
__host__ __device__ __forceinline__ void stage_rc(int b, int& R, int& C) { const int st = b / 1024, sb = b % 1024, swz = sb ^ (((sb >> 9) & 1) << 5); R = (st >> 1) * 16 + swz / 64; C = (st & 1) * 32 + (swz % 64) / 2; }
__host__ __device__ __forceinline__ int perm32(int rho) { const int n = rho >> 4, i = rho & 15; return 8 * (i >> 2) + 4 * n + (i & 3); }

struct Unit { int pm, pn, ks; };
struct Gemm { const bf16_t* A; const bf16_t* Bt; int lda, ldb, Ks; };

struct Order {
    int nM, nN, nS, nwg, G, c;
    __device__ void init(int M, int N, int S, int G_, int c_) { nM = M / BM; nN = N / BM; nS = S; nwg = nM * nN * nS; G = G_; c = c_; }
    __device__ bool next(int i, Unit& u) const {
        const long L = (long)i * G + c; if (L >= nwg) return false;
        int wgid = (int)L; { const int q = nwg / NXCD, r = nwg % NXCD, xcd = wgid % NXCD, off = wgid / NXCD; wgid = (xcd < r ? xcd * (q + 1) : r * (q + 1) + (xcd - r) * q) + off; }
        const int nNs = nN * nS;
        const int nig = WGM * nNs, gid = wgid / nig, fm = gid * WGM, gsz = (nM - fm) < WGM ? (nM - fm) : WGM;
        u.pm = fm + ((wgid % nig) % gsz); const int pns = (wgid % nig) / gsz; u.pn = pns / nS; u.ks = pns % nS; return true;
    }
};


struct EpiBf16 {
    static constexpr bool PERM = true;
    bf16_t* O; int ldc; int scale_cols; float scale0; float* dumpk; float* dumpv;
    __device__ __forceinline__ void operator()(const f32x4 (&acc)[2][2][4][2], const Unit& u, int wr, int wc, int fr, int fq) const {
        const int row0 = u.pm * BM + wr * 64 + fr, colt = u.pn * BM;
        const float sc = (colt < scale_cols) ? scale0 : 1.f;
        const int col0 = colt + wc * 32 + 8 * fq;
        float* dump = nullptr; int dcol = 0;
        if (dumpk && u.pm < 16 && colt >= 1024) { dump = colt >= 2048 ? dumpv : dumpk; dcol = col0 - (colt >= 2048 ? 2048 : 1024); }
#pragma unroll
        for (int ai = 0; ai < 2; ++ai)
#pragma unroll
            for (int m = 0; m < 4; ++m) { const int row = row0 + ai * HALF + m * 16; bf16_t* rowp = O + (size_t)row * ldc + col0;
#pragma unroll
                for (int bj = 0; bj < 2; ++bj) { const f32x4 v0 = acc[ai][bj][m][0] * sc, v1 = acc[ai][bj][m][1] * sc;
                    u32x4 w; w.x = cvtpk(v0[0], v0[1]); w.y = cvtpk(v0[2], v0[3]); w.z = cvtpk(v1[0], v1[1]); w.w = cvtpk(v1[2], v1[3]);
                    *(u32x4*)(rowp + bj * HALF) = w;
                    if (dump) { float* dp = dump + ((size_t)((row >> 8) * 2) * 256 + (row & 255)) * 1024 + dcol + bj * HALF; *(f32x4*)dp = v0; *(f32x4*)(dp + 4) = v1; } } }
    }
};
struct EpiSwiglu {
    static constexpr bool PERM = true;
    bf16_t* O; int ldc;
    __device__ __forceinline__ void operator()(const f32x4 (&acc)[2][2][4][2], const Unit& u, int wr, int wc, int fr, int fq) const {
        const int row0 = u.pm * BM + wr * 64 + fr, col0 = u.pn * HALF + wc * 32 + 8 * fq;
#pragma unroll
        for (int ai = 0; ai < 2; ++ai)
#pragma unroll
            for (int m = 0; m < 4; ++m) { bf16_t* rowp = O + (size_t)(row0 + ai * HALF + m * 16) * ldc + col0;
                const f32x4 g0 = acc[ai][0][m][0], g1 = acc[ai][0][m][1], u0 = acc[ai][1][m][0], u1 = acc[ai][1][m][1];
                u32x4 w; w.x = cvtpk(silu_f(g0[0]) * u0[0], silu_f(g0[1]) * u0[1]); w.y = cvtpk(silu_f(g0[2]) * u0[2], silu_f(g0[3]) * u0[3]);
                w.z = cvtpk(silu_f(g1[0]) * u1[0], silu_f(g1[1]) * u1[1]); w.w = cvtpk(silu_f(g1[2]) * u1[2], silu_f(g1[3]) * u1[3]);
                *(u32x4*)rowp = w; }
    }
};
struct EpiF32 {
    static constexpr bool PERM = false;
    float* Y; int ldc; size_t slab;
    __device__ __forceinline__ void operator()(const f32x4 (&acc)[2][2][4][2], const Unit& u, int wr, int wc, int fr, int fq) const {
        float* base = Y + (size_t)u.ks * slab; const int col0 = u.pn * BM + wc * 32 + 4 * fq;
#pragma unroll
        for (int ai = 0; ai < 2; ++ai)
#pragma unroll
            for (int m = 0; m < 4; ++m) { float* rowp = base + (size_t)(u.pm * BM + ai * HALF + wr * 64 + m * 16 + fr) * ldc + col0;
#pragma unroll
                for (int bj = 0; bj < 2; ++bj)
#pragma unroll
                    for (int n = 0; n < 2; ++n) *(f32x4*)(rowp + bj * HALF + n * 16) = acc[ai][bj][m][n]; }
    }
};

template <class Epi>
__device__ __forceinline__ void gemm_phase(LAS unsigned char* lds, const int tid, const Gemm g, const Order& S, const Epi& E) {
    const int wid = __builtin_amdgcn_readfirstlane(tid >> 6), lane = tid & 63, wr = wid >> 2, wc = wid & 3, fr = lane & 15, fq = lane >> 4;
    const int nt = g.Ks / BK;
    unsigned voffA[2], voffB[2];
#pragma unroll
    for (int i = 0; i < 2; ++i) { int R, C; stage_rc(tid * 16 + i * 8192, R, C); const int Rb = Epi::PERM ? ((R & ~31) + perm32(R & 31)) : R;
        voffA[i] = (unsigned)(R * g.lda + C) * 2u; voffB[i] = (unsigned)(Rb * g.ldb + C) * 2u; }
    const size_t kstep = (size_t)(BK * 2);
    const size_t hstepA = (size_t)HALF * g.lda * 2, hstepB = (size_t)HALF * g.ldb * 2;
    const unsigned ldsw = (unsigned)wid * 1024u;
    const int aoff = lds_byte(wr * 64 + fr, fq * 8), boff = lds_byte(wc * 32 + fr, fq * 8);
#define PG8_SA(b, h) (((b) * 2 + (h)) * HTB)
#define PG8_SB(b, h) ((4 + (b) * 2 + (h)) * HTB)
#define PG8_STAGE(bufoff, gbase, voff) do { _Pragma("unroll") for (int _i = 0; _i < 2; ++_i) \
        __builtin_amdgcn_global_load_lds((const unsigned*)((const char*)(gbase) + (voff)[_i]), (LAS unsigned*)(lds + (bufoff) + ldsw + _i * 8192), 16, 0, 0); } while (0)
#define PG8_LDA(dst, b, h) do { _Pragma("unroll") for (int m = 0; m < 4; ++m) _Pragma("unroll") for (int k = 0; k < 2; ++k) dst[m][k] = *(const LAS bf16x8*)(lds + PG8_SA(b, h) + aoff + m * 2048 + k * 1024); } while (0)
#define PG8_LDB(dst, b, h) do { _Pragma("unroll") for (int n = 0; n < 2; ++n) _Pragma("unroll") for (int k = 0; k < 2; ++k) dst[n][k] = *(const LAS bf16x8*)(lds + PG8_SB(b, h) + boff + n * 2048 + k * 1024); } while (0)
#define PG8_MMA(ai, bj, At, Bt) do { __builtin_amdgcn_s_setprio(1); _Pragma("unroll") for (int m = 0; m < 4; ++m) _Pragma("unroll") for (int n = 0; n < 2; ++n) _Pragma("unroll") for (int k = 0; k < 2; ++k) \
        acc[ai][bj][m][n] = __builtin_amdgcn_mfma_f32_16x16x32_bf16(Bt[n][k], At[m][k], acc[ai][bj][m][n], 0, 0, 0); __builtin_amdgcn_s_setprio(0); } while (0)
#define PG8_WAIT_V(n) asm volatile("s_waitcnt vmcnt(" #n ")" ::: "memory")
#define PG8_WAIT_L(n) asm volatile("s_waitcnt lgkmcnt(" #n ")" ::: "memory")
#define PG8_BAR __builtin_amdgcn_s_barrier()
#define PG8_SCHED __builtin_amdgcn_sched_barrier(0)
#define PG8_UA(u) ((const char*)g.A + ((size_t)(u).pm * BM * g.lda + (size_t)(u).ks * g.Ks) * 2)
#define PG8_UB(u) ((const char*)g.Bt + ((size_t)(u).pn * BM * g.ldb + (size_t)(u).ks * g.Ks) * 2)
    Unit cur, nxt; int ui = 0;
    if (!S.next(0, cur)) return;
    f32x4 acc[2][2][4][2];
#pragma unroll
    for (int a = 0; a < 2; ++a)
#pragma unroll
        for (int b = 0; b < 2; ++b)
#pragma unroll
            for (int m = 0; m < 4; ++m)
#pragma unroll
                for (int n = 0; n < 2; ++n) acc[a][b][m][n] = (f32x4){0.f, 0.f, 0.f, 0.f};
    bf16x8 At[4][2], B0[2][2], B1[2][2];
    const char* cA = PG8_UA(cur); const char* cB = PG8_UB(cur);
    PG8_STAGE(PG8_SB(0, 0), cB, voffB); PG8_STAGE(PG8_SB(0, 1), cB + hstepB, voffB); PG8_STAGE(PG8_SA(0, 0), cA, voffA); PG8_STAGE(PG8_SA(0, 1), cA + hstepA, voffA);
    if (wr == 1) PG8_BAR;
    PG8_WAIT_V(2); PG8_BAR;
    PG8_STAGE(PG8_SB(1, 0), cB + kstep, voffB); PG8_STAGE(PG8_SA(1, 0), cA + kstep, voffA); PG8_STAGE(PG8_SB(1, 1), cB + hstepB + kstep, voffB);
    PG8_WAIT_V(6); PG8_BAR;
    for (;;) {
        const bool has_next = S.next(ui + 1, nxt);
        const char* nA = has_next ? PG8_UA(nxt) : cA; const char* nB = has_next ? PG8_UB(nxt) : cB;
        for (int t = 0; t < nt; t += 2) {
            const bool last = (t == nt - 2);
            const char* a1 = cA + (size_t)(t + 1) * kstep;
            const char* a2 = last ? nA : cA + (size_t)(t + 2) * kstep; const char* b2 = last ? nB : cB + (size_t)(t + 2) * kstep;
            const char* a3 = a2 + kstep; const char* b3 = b2 + kstep;
            PG8_LDB(B0, 0, 0); PG8_LDB(B1, 0, 1); PG8_SCHED; PG8_LDA(At, 0, 0); PG8_STAGE(PG8_SA(1, 1), a1 + hstepA, voffA);
            PG8_WAIT_V(8); PG8_WAIT_L(0); PG8_BAR; PG8_MMA(0, 0, At, B0); PG8_MMA(0, 1, At, B1); PG8_BAR; PG8_SCHED;
            PG8_LDA(At, 0, 1); PG8_STAGE(PG8_SB(0, 0), b2, voffB); PG8_STAGE(PG8_SB(0, 1), b2 + hstepB, voffB); PG8_STAGE(PG8_SA(0, 0), a2, voffA);
            PG8_WAIT_V(8); PG8_WAIT_L(0); PG8_BAR; PG8_MMA(1, 0, At, B0); PG8_MMA(1, 1, At, B1); PG8_BAR; PG8_SCHED;
            PG8_LDB(B0, 1, 0); PG8_LDB(B1, 1, 1); PG8_SCHED; PG8_LDA(At, 1, 0); PG8_STAGE(PG8_SA(0, 1), a2 + hstepA, voffA);
            PG8_WAIT_V(8); PG8_WAIT_L(0); PG8_BAR; PG8_MMA(0, 0, At, B0); PG8_MMA(0, 1, At, B1); PG8_BAR; PG8_SCHED;
            PG8_LDA(At, 1, 1); PG8_STAGE(PG8_SB(1, 0), b3, voffB); PG8_STAGE(PG8_SB(1, 1), b3 + hstepB, voffB); PG8_STAGE(PG8_SA(1, 0), a3, voffA);
            PG8_WAIT_V(8); PG8_WAIT_L(0); PG8_BAR; PG8_MMA(1, 0, At, B0); PG8_MMA(1, 1, At, B1); PG8_BAR; PG8_SCHED;
        }
        if (wr == 0) PG8_BAR;
        E(acc, cur, wr, wc, fr, fq);
        if (!has_next) break;
#pragma unroll
        for (int a = 0; a < 2; ++a)
#pragma unroll
            for (int b = 0; b < 2; ++b)
#pragma unroll
                for (int m = 0; m < 4; ++m)
#pragma unroll
                    for (int n = 0; n < 2; ++n) acc[a][b][m][n] = (f32x4){0.f, 0.f, 0.f, 0.f};
        cur = nxt; cA = nA; cB = nB; ++ui;
        if (wr == 1) PG8_BAR;
    }
    PG8_WAIT_V(0);
    PG8_BAR;
#undef PG8_SA
#undef PG8_SB
#undef PG8_STAGE
#undef PG8_LDA
#undef PG8_LDB
#undef PG8_MMA
#undef PG8_WAIT_V
#undef PG8_WAIT_L
#undef PG8_BAR
#undef PG8_SCHED
#undef PG8_UA
#undef PG8_UB
}
}

namespace att {
constexpr int LDS_K = 0, LDS_V = 8192, LDS_WS = 16384, LDS_OST = LDS_WS + 2048, LDS_RPB = LDS_OST + 32768, LDS_END = LDS_RPB + 2048;
__device__ __forceinline__ int crow(int r, int hi) { return (r & 3) + 8 * (r >> 2) + 4 * hi; }
#define ATT_SBAR() __builtin_amdgcn_sched_barrier(0)
__device__ __forceinline__ void pv(f32x16* o, unsigned vb, bf16x8 pa0, bf16x8 pa1, bf16x8 pa2, bf16x8 pa3) {
#pragma unroll
    for (int d0 = 0; d0 < 2; ++d0) { s16x4 lo[4], hi[4];
#pragma unroll
        for (int ks = 0; ks < 4; ++ks) {
            asm volatile("ds_read_b64_tr_b16 %0,%1 offset:%c2" : "=&v"(lo[ks]) : "v"(vb), "i"(d0 * 4096 + ks * 1024) : "memory");
            asm volatile("ds_read_b64_tr_b16 %0,%1 offset:%c2" : "=&v"(hi[ks]) : "v"(vb), "i"(d0 * 4096 + ks * 1024 + 512) : "memory"); }
        asm volatile("s_waitcnt lgkmcnt(0)" ::: "memory"); ATT_SBAR();
#define ATT_PK(k) (bf16x8){lo[k][0], lo[k][1], lo[k][2], lo[k][3], hi[k][0], hi[k][1], hi[k][2], hi[k][3]}
        o[d0] = __builtin_amdgcn_mfma_f32_32x32x16_bf16(pa0, ATT_PK(0), o[d0], 0, 0, 0);
        o[d0] = __builtin_amdgcn_mfma_f32_32x32x16_bf16(pa1, ATT_PK(1), o[d0], 0, 0, 0);
        o[d0] = __builtin_amdgcn_mfma_f32_32x32x16_bf16(pa2, ATT_PK(2), o[d0], 0, 0, 0);
        o[d0] = __builtin_amdgcn_mfma_f32_32x32x16_bf16(pa3, ATT_PK(3), o[d0], 0, 0, 0);
#undef ATT_PK
    }
}
struct NoMask { __device__ __forceinline__ void operator()(f32x16&, f32x16&, int, int, int) const {} };
struct NaMask {
    const LAS float* rpb; int rq, wq0, lo;
    __device__ __forceinline__ void operator()(f32x16& p0, f32x16& p1, int t, int r32, int hi) const {
        if (t < 4) return;
        const int kr = lo + t - 4; int rs = rq - 4; rs = rs < 0 ? 0 : (rs > 8 ? 8 : rs);
        const float NEG = -INFINITY;
        if (kr < rs || kr >= rs + 8) {
#pragma unroll
            for (int r = 0; r < 16; ++r) { p0[r] = NEG; p1[r] = NEG; }
            return; }
        const int wq = wq0 + r32; int cs = wq - 8; cs = cs < 0 ? 0 : (cs > 48 ? 48 : cs);
        const LAS float* rb = rpb + (kr - rq + 7) * 31 + 15 - wq;
#pragma unroll
        for (int r = 0; r < 16; ++r) { const int wk = crow(r, hi);
            { const bool ok = (wk >= cs) && (wk < cs + 16); const float bv = rb[ok ? wk : wq]; p0[r] = ok ? p0[r] + bv : NEG; }
            { const int wk2 = wk + 32; const bool ok = (wk2 >= cs) && (wk2 < cs + 16); const float bv = rb[ok ? wk2 : wq]; p1[r] = ok ? p1[r] + bv : NEG; } }
    }
};
template <class Src, class Mask>
__device__ __forceinline__ void unit(const int tid, const bf16_t* Qw, int qp, bf16_t* Ow, int op, int NT, const Src& src, const Mask& mask, LAS unsigned char* shm) {
    const int lane = tid & 63, r32 = lane & 31, hi = lane >> 5; const int wid = __builtin_amdgcn_readfirstlane(tid >> 6);
    bf16x8 qr[4];
#pragma unroll
    for (int d0 = 0; d0 < 4; ++d0) qr[d0] = *(const bf16x8*)(Qw + (size_t)r32 * qp + d0 * 16 + hi * 8);
    float mhat = 0.f, l_reg = 0.f; f32x16 o[2];
#pragma unroll
    for (int r = 0; r < 16; ++r) { o[0][r] = 0.f; o[1][r] = 0.f; }
    LAS float* wsf = (LAS float*)(shm + LDS_WS) + wid * 64;
    const unsigned vb0 = (unsigned)(uintptr_t)(shm + LDS_V) + ((lane >> 4) & 1) * 32 + (lane & 3) * 8 + (4 * hi + ((lane & 15) >> 2)) * 64;
    const LAS unsigned char* kbp = shm + LDS_K + hi * 1024 + r32 * 16;
    for (int t = 0; t < NT; ++t) {
        __syncthreads();
        { const bf16_t* kb; const bf16_t* vb; int kp, vp; src.tile(t, kb, kp, vb, vp);
          const u32x4 kv = *(const u32x4*)(kb + (size_t)lane * kp + wid * 8);
          const u32x4 vv = *(const u32x4*)(vb + (size_t)(16 * (wid & 3) + (lane >> 2)) * vp + (wid >> 2) * 32 + (lane & 3) * 8);
          *(LAS u32x4*)(shm + LDS_K + wid * 1024 + lane * 16) = kv;
          *(LAS u32x4*)(shm + LDS_V + wid * 1024 + lane * 16) = vv; }
        __syncthreads();
        f32x16 p0, p1;
#pragma unroll
        for (int r = 0; r < 16; ++r) { p0[r] = -mhat; p1[r] = -mhat; }
#pragma unroll
        for (int d0 = 0; d0 < 4; ++d0) {
            const bf16x8 b0 = *(const LAS bf16x8*)(kbp + d0 * 2048);
            const bf16x8 b1 = *(const LAS bf16x8*)(kbp + d0 * 2048 + 512);
            p0 = __builtin_amdgcn_mfma_f32_32x32x16_bf16(b0, qr[d0], p0, 0, 0, 0);
            p1 = __builtin_amdgcn_mfma_f32_32x32x16_bf16(b1, qr[d0], p1, 0, 0, 0); }
        mask(p0, p1, t, r32, hi);
        float rm = __builtin_fmaxf(p0[0], p1[0]);
#pragma unroll
        for (int r = 1; r < 16; ++r) rm = __builtin_fmaxf(rm, __builtin_fmaxf(p0[r], p1[r]));
        rm = __builtin_fmaxf(rm, __shfl_xor(rm, 32));
        const float dl = (t == 0) ? rm : __builtin_fmaxf(rm, 0.f);
        const float f = (t == 0) ? 1.f : fast_exp2(-dl);
        mhat += dl;
        float sacc = 0.f;
#pragma unroll
        for (int r = 0; r < 16; ++r) { p0[r] = fast_exp2(p0[r] - dl); p1[r] = fast_exp2(p1[r] - dl); sacc += p0[r] + p1[r]; }
        l_reg = l_reg * f + sacc;
        if (t > 0 && __any(dl > 0.f)) {
            if (hi == 0) wsf[r32] = f;
            asm volatile("s_waitcnt lgkmcnt(0)" ::: "memory");
#pragma unroll
            for (int r = 0; r < 16; ++r) { const float fr_ = wsf[crow(r, hi)]; o[0][r] *= fr_; o[1][r] *= fr_; }
        }
        u32x4 pw0, pw1, pw2, pw3;
        pw0 = (u32x4){cvtpk(p0[0], p0[1]), cvtpk(p0[2], p0[3]), cvtpk(p0[4], p0[5]), cvtpk(p0[6], p0[7])};
        pw1 = (u32x4){cvtpk(p0[8], p0[9]), cvtpk(p0[10], p0[11]), cvtpk(p0[12], p0[13]), cvtpk(p0[14], p0[15])};
        pw2 = (u32x4){cvtpk(p1[0], p1[1]), cvtpk(p1[2], p1[3]), cvtpk(p1[4], p1[5]), cvtpk(p1[6], p1[7])};
        pw3 = (u32x4){cvtpk(p1[8], p1[9]), cvtpk(p1[10], p1[11]), cvtpk(p1[12], p1[13]), cvtpk(p1[14], p1[15])};
        ATT_SBAR();
        pv(o, vb0, __builtin_bit_cast(bf16x8, pw0), __builtin_bit_cast(bf16x8, pw1), __builtin_bit_cast(bf16x8, pw2), __builtin_bit_cast(bf16x8, pw3));
    }
    l_reg += __shfl_xor(l_reg, 32);
    if (hi == 0) wsf[32 + r32] = l_reg;
    asm volatile("s_waitcnt lgkmcnt(0)" ::: "memory");
    float rli[16];
#pragma unroll
    for (int r = 0; r < 16; ++r) rli[r] = fast_rcp(wsf[32 + crow(r, hi)]);
    LAS bf16_t* stg = (LAS bf16_t*)(shm + LDS_OST) + wid * 2048;
#pragma unroll
    for (int r = 0; r < 16; ++r) { const int orow = crow(r, hi);
#pragma unroll
        for (int d0 = 0; d0 < 2; ++d0) stg[orow * 64 + d0 * 32 + r32] = (bf16_t)(cvtpk(o[d0][r] * rli[r], 0.f) & 0xffffu); }
    asm volatile("s_waitcnt lgkmcnt(0)" ::: "memory");
#pragma unroll
    for (int i = 0; i < 4; ++i) { const int row = i * 8 + (lane >> 3), ch = lane & 7; const u32x4 v = *(const LAS u32x4*)(stg + row * 64 + ch * 8); *(u32x4*)(Ow + (size_t)row * op + ch * 8) = v; }
}
}

#define XB_TMO      128
#define XB_XCNT(j)  (256  + 64 * (j))
#define XB_XSUB(j)  (1280 + 64 * (j))
#define XB_XGEN(j)  (2304 + 64 * (j))
#define XB_TOP      3328
#define XB_TOPGEN   3392
#define XCD_BAR_WORDS 3456
#define XB_SPIN_CAP (1u << 18)
__device__ __forceinline__ unsigned xb_ld(unsigned* p)              { return __hip_atomic_load(p, __ATOMIC_RELAXED, __HIP_MEMORY_SCOPE_AGENT); }
__device__ __forceinline__ unsigned xb_add(unsigned* p, unsigned v) { return __hip_atomic_fetch_add(p, v, __ATOMIC_RELAXED, __HIP_MEMORY_SCOPE_AGENT); }
__device__ __forceinline__ unsigned xb_xcc_id() { return (unsigned)__builtin_amdgcn_s_getreg((3 << 11) | 20) & 0xFu; }
#define XB_SPIN(cond, bar) do { unsigned _sp = 0; while (cond) { __builtin_amdgcn_s_sleep(1); \
    if ((++_sp & 255u) == 0u) { if (xb_ld(&(bar)[XB_TMO])) break; if (_sp > XB_SPIN_CAP) { atomicAdd(&(bar)[XB_TMO], 1u); break; } } } } while (0)
struct XcdBarrier { unsigned* bar; unsigned x; volatile LAS unsigned* st; };
__device__ __forceinline__ XcdBarrier xcd_barrier_post(unsigned* bar, volatile LAS unsigned* st) {
    XcdBarrier b; b.bar = bar; b.x = xb_xcc_id(); b.st = st;
    if (threadIdx.x == 0) (void)xb_add(&bar[XB_XCNT(b.x)], 1u);
    return b;
}
__device__ __forceinline__ void xcd_barrier_complete(unsigned* bar, unsigned x, unsigned& nloc, unsigned& nx) {
    const unsigned G = gridDim.x * gridDim.y * gridDim.z;
    unsigned sum, cnt, mine, sp = 0u;
    for (;;) {
        sum = 0u; cnt = 0u; mine = 0u;
#pragma unroll
        for (unsigned j = 0; j < 16; ++j) { const unsigned c = xb_ld(&bar[XB_XCNT(j)]); sum += c; cnt += (c > 0u) ? 1u : 0u; mine = (j == x) ? c : mine; }
        if (sum == G) break;
        __builtin_amdgcn_s_sleep(1);
        if ((++sp & 255u) == 0u) { if (xb_ld(&bar[XB_TMO])) break; if (sp > XB_SPIN_CAP) { atomicAdd(&bar[XB_TMO], 1u); break; } }
    }
    nloc = mine > 0u ? mine : 1u; nx = cnt > 0u ? cnt : 1u;
}
__device__ __forceinline__ void xcd_barrier(const XcdBarrier& b) {
    asm volatile("s_waitcnt vmcnt(0)" ::: "memory");
    __syncthreads();
    if (threadIdx.x == 0) {
        unsigned* bar = b.bar;
        __builtin_amdgcn_s_waitcnt(0);
        unsigned nloc = b.st[0], nx = b.st[1];
        if (nloc == 0u) { xcd_barrier_complete(bar, b.x, nloc, nx); b.st[0] = nloc; b.st[1] = nx; }
        const unsigned old = xb_add(&bar[XB_XSUB(b.x)], 1u);
        const unsigned gen = old / nloc;
        if (old + 1u == (gen + 1u) * nloc) {
            __builtin_amdgcn_fence(__ATOMIC_RELEASE, "agent");
            asm volatile("s_waitcnt vmcnt(0)" ::: "memory");
            const unsigned og = xb_add(&bar[XB_TOP], 1u);
            const unsigned tg = og / nx;
            if (og + 1u == (tg + 1u) * nx) xb_add(&bar[XB_TOPGEN], 1u);
            else XB_SPIN(xb_ld(&bar[XB_TOPGEN]) == tg, bar);
            __builtin_amdgcn_fence(__ATOMIC_ACQUIRE, "agent");
            xb_add(&bar[XB_XGEN(b.x)], 1u);
            asm volatile("s_waitcnt vmcnt(0)" ::: "memory");
        } else {
            XB_SPIN(xb_ld(&bar[XB_XGEN(b.x)]) == gen, bar);
            __builtin_amdgcn_fence(__ATOMIC_ACQUIRE, "agent");
            asm volatile("s_waitcnt vmcnt(0)" ::: "memory");
        }
    }
    __syncthreads();
}

constexpr int NWAVES = 8;
constexpr int RING_BYTES = 131072, LDSCTL_OFF = RING_BYTES, MISC_OFF = LDSCTL_OFF + 320, LDS_BYTES = 147456;
constexpr int CW_BAR = 4096;

struct Args {
    const float* in[26]; float* out; unsigned char* ws; int ph_lo, ph_hi;
};
struct Frame {
    LAS unsigned char* lds; int tid, lane, wave, G, bid; unsigned char* ws; float* out;
};
__device__ __forceinline__ const float* inp(int i) {
    auto kp = __builtin_amdgcn_kernarg_segment_ptr();
    asm volatile("" : "+s"(kp));
    return ((const float* const __attribute__((address_space(4)))*)kp)[i];
}
enum { I_XP = 0, I_XS, I_CAK, I_CAV, I_CNK, I_CNV, I_C, I_CCTX, I_MODW, I_MODB, I_NMPRE, I_NMPOST, I_NFPRE, I_NFPOST, I_EWIN, I_EWOUT, I_SGUW, I_SGUB, I_SGUN, I_QN, I_KN, I_OWIN, I_OWOUT, I_RPB, I_FWIN, I_FWOUT };

template <class RowMap>
__device__ __forceinline__ void transpose_item(const float* W, int K, int N, bf16_t* WT, const RowMap& rmap, LAS float* scr, int item, int lane) {
    const int nblk = N / 32, kb = item / nblk, nb = item % nblk, k0 = 64 * kb, n0 = 32 * nb;
#pragma unroll 8
    for (int i = 0; i < 32; ++i) { const int kk = 2 * i + (lane >> 5); scr[kk * 33 + (lane & 31)] = W[(size_t)(k0 + kk) * N + n0 + (lane & 31)]; }
    asm volatile("s_waitcnt lgkmcnt(0)" ::: "memory");
    const int c = lane & 7; const int r0 = rmap(n0);
#pragma unroll
    for (int j = 0; j < 4; ++j) { const int n = (lane >> 3) + 8 * j; const LAS float* s = scr + (8 * c) * 33 + n;
        u32x4 o; o.x = cvtpk(s[0 * 33], s[1 * 33]); o.y = cvtpk(s[2 * 33], s[3 * 33]); o.z = cvtpk(s[4 * 33], s[5 * 33]); o.w = cvtpk(s[6 * 33], s[7 * 33]);
        *(u32x4*)(WT + (size_t)(r0 + n) * K + k0 + 8 * c) = o; }
    asm volatile("s_waitcnt lgkmcnt(0)" ::: "memory");
}
struct MapId { __device__ __forceinline__ int operator()(int n0) const { return n0; } };
struct MapSwiglu { __device__ __forceinline__ int operator()(int n0) const { const bool isu = n0 >= DFF; const int j = isu ? n0 - DFF : n0; return 256 * (j >> 7) + (isu ? 128 : 0) + (j & 127); } };

__device__ __forceinline__ void p0_prologue(const Frame& F) {
    const int gw = F.bid * NWAVES + F.wave, NGW = F.G * NWAVES;
    {
        LAS float* scr = (LAS float*)(F.lds + F.wave * 16384);
        constexpr int IT_EIN = (DM / 64) * (EVEN_IN / 32), IT_SQ = (DM / 64) * (DM / 32), IT_OIN = (DM / 64) * (ODD_IN / 32), IT_FI = (DM / 64) * (2 * DFF / 32), IT_FO = (DFF / 64) * (DM / 32);
        constexpr int NITEMS = 2 * IT_EIN + 2 * IT_SQ + 2 * IT_OIN + 2 * IT_SQ + 4 * IT_FI + 4 * IT_FO;
        for (int it = gw; it < NITEMS; it += NGW) {
            int r = it;
            if (r < 2 * IT_EIN) { const int e = r / IT_EIN; r %= IT_EIN; transpose_item(inp(I_EWIN) + (size_t)e * DM * EVEN_IN, DM, EVEN_IN, (bf16_t*)(F.ws + WS_WINE) + (size_t)e * EVEN_IN * DM, MapId(), scr, r, F.lane); continue; } r -= 2 * IT_EIN;
            if (r < 2 * IT_SQ) { const int e = r / IT_SQ; r %= IT_SQ; transpose_item(inp(I_EWOUT) + (size_t)e * DM * DM, DM, DM, (bf16_t*)(F.ws + WS_WOUTE) + (size_t)e * DM * DM, MapId(), scr, r, F.lane); continue; } r -= 2 * IT_SQ;
            if (r < 2 * IT_OIN) { const int e = r / IT_OIN; r %= IT_OIN; transpose_item(inp(I_OWIN) + (size_t)e * DM * ODD_IN, DM, ODD_IN, (bf16_t*)(F.ws + WS_WINO) + (size_t)e * ODD_IN * DM, MapId(), scr, r, F.lane); continue; } r -= 2 * IT_OIN;
            if (r < 2 * IT_SQ) { const int e = r / IT_SQ; r %= IT_SQ; transpose_item(inp(I_OWOUT) + (size_t)e * DM * DM, DM, DM, (bf16_t*)(F.ws + WS_WOUTO) + (size_t)e * DM * DM, MapId(), scr, r, F.lane); continue; } r -= 2 * IT_SQ;
            if (r < 4 * IT_FI) { const int e = r / IT_FI; r %= IT_FI; transpose_item(inp(I_FWIN) + (size_t)e * DM * 2 * DFF, DM, 2 * DFF, (bf16_t*)(F.ws + WS_WFI) + (size_t)e * 2 * DFF * DM, MapSwiglu(), scr, r, F.lane); continue; } r -= 4 * IT_FI;
            { const int e = r / IT_FO; r %= IT_FO; transpose_item(inp(I_FWOUT) + (size_t)e * DFF * DM, DFF, DM, (bf16_t*)(F.ws + WS_WFO) + (size_t)e * DM * DFF, MapId(), scr, r, F.lane); }
        }
    }
    __syncthreads();
    {
        LAS float* sc = (LAS float*)F.lds;
        LAS float* red = (LAS float*)(F.lds + 20480);
        if (F.bid < 384) {
            for (int i = F.tid; i < 5 * 1024; i += 512) { const int cd = i >> 10, k = i & 1023; const float v = cd == 0 ? inp(I_CCTX)[k] : inp(I_C)[(cd - 1) * 1024 + k]; sc[i] = silu_f(v); }
        }
        __syncthreads();
        for (int it = F.bid; it < 384; it += F.G) {
            const int l = it / 96, ch = it % 96;
            const float* W = inp(I_MODW) + (size_t)l * 1024 * 6144 + ch * 64;
            const int cg = F.lane & 15, ks = F.lane >> 4;
            f32x4 acc[5];
#pragma unroll
            for (int c = 0; c < 5; ++c) acc[c] = (f32x4){0.f, 0.f, 0.f, 0.f};
#pragma unroll 4
            for (int i = 0; i < 32; ++i) { const int k = 128 * F.wave + 4 * i + ks; const f32x4 w = *(const f32x4*)(W + (size_t)k * 6144 + 4 * cg);
#pragma unroll
                for (int c = 0; c < 5; ++c) acc[c] += w * sc[c * 1024 + k]; }
#pragma unroll
            for (int c = 0; c < 5; ++c)
#pragma unroll
                for (int j = 0; j < 4; ++j) { float v = acc[c][j]; v += __shfl_xor(v, 16); v += __shfl_xor(v, 32); acc[c][j] = v; }
            if (ks == 0) {
#pragma unroll
                for (int c = 0; c < 5; ++c)
#pragma unroll
                    for (int j = 0; j < 4; ++j) red[(F.wave * 5 + c) * 64 + 4 * cg + j] = acc[c][j]; }
            __syncthreads();
            if (F.tid < 320) { const int c = F.tid >> 6, col = F.tid & 63; float s = inp(I_MODB)[l * 6144 + ch * 64 + col];
#pragma unroll
                for (int w = 0; w < 8; ++w) s += red[(w * 5 + c) * 64 + col];
                ((float*)(F.ws + WS_MOD))[((size_t)l * 5 + c) * 6144 + ch * 64 + col] = s; }
            __syncthreads();
        }
    }
    {
        const int gt = F.bid * 512 + F.tid, NGT = F.G * 512;
        for (int i = gt; i < 4 * 2 * 256 * 32; i += NGT) { const int q = i & 31, j = (i >> 5) & 255, e = (i >> 13) & 1, b = i >> 14;
            const size_t so = (size_t)i * 4; const size_t dof = ((size_t)(e * 4 + b) * 1280 + 1024 + j) * 128 + q * 4;
            const f32x4 k = *(const f32x4*)(inp(I_CAK) + so), v = *(const f32x4*)(inp(I_CAV) + so);
            *(u32x2*)((bf16_t*)(F.ws + WS_KS) + dof) = (u32x2){cvtpk(k[0], k[1]), cvtpk(k[2], k[3])};
            *(u32x2*)((bf16_t*)(F.ws + WS_VS) + dof) = (u32x2){cvtpk(v[0], v[1]), cvtpk(v[2], v[3])}; }
        for (int i = gt; i < 4 * 2 * 256 * 256; i += NGT) { const int q = i & 255, j = (i >> 8) & 255, o = (i >> 16) & 1, b = i >> 17;
            const size_t so = (size_t)i * 4; const size_t dof = ((size_t)(o * 4 + b) * 256 + j) * 1024 + q * 4;
            const f32x4 k = *(const f32x4*)(inp(I_CNK) + so), v = *(const f32x4*)(inp(I_CNV) + so);
            *(u32x2*)((bf16_t*)(F.ws + WS_CK) + dof) = (u32x2){cvtpk(k[0], k[1]), cvtpk(k[2], k[3])};
            *(u32x2*)((bf16_t*)(F.ws + WS_CV) + dof) = (u32x2){cvtpk(v[0], v[1]), cvtpk(v[2], v[3])}; }
        for (int i = gt; i < 2 * 4 * 128 * 128 / 4; i += NGT) { const f32x4 w = *(const f32x4*)(inp(I_SGUW) + (size_t)i * 4);
            *(u32x2*)((bf16_t*)(F.ws + WS_SGUW) + (size_t)i * 4) = (u32x2){cvtpk(w[0], w[1]), cvtpk(w[2], w[3])}; }
        for (int i = gt; i < 64 * 16; i += NGT) { const int pos = i >> 4, fi = i & 15;
            const float fr = exp2f(-(float)fi * (13.287712379549449f / 16.0f)); const float a = (float)pos * fr;
            ((f32x2*)(F.ws + WS_ROPE))[i] = (f32x2){cosf(a), sinf(a)}; }
    }
}

template <bool HAS_Y, bool HAS_H>
__device__ __forceinline__ void norm_phase(const Frame& F, const float* xin_p, const float* xin_s, const float* y0, const float* y1, const float* gpost, int gate_ch,
                                           float* xout, const float* gpre, const float* modl_h, int scale_ch, int shift_ch, const float* modl_y, bf16_t* H) {
    const int gw = F.bid * NWAVES + F.wave, NGW = F.G * NWAVES;
    for (int row = gw; row < NTOK; row += NGW) {
        const int cond = row < NPR ? 0 : 1 + ((row - NPR) >> 10);
        const float* xr = row < NPR ? xin_p + (size_t)row * DM : xin_s + (size_t)(row - NPR) * DM;
        f32x4 x[4];
#pragma unroll
        for (int j = 0; j < 4; ++j) x[j] = *(const f32x4*)(xr + 4 * (F.lane + 64 * j));
        if (HAS_Y) {
            f32x4 y[4]; float ss = 0.f;
#pragma unroll
            for (int j = 0; j < 4; ++j) { y[j] = *(const f32x4*)(y0 + (size_t)row * DM + 4 * (F.lane + 64 * j)) + *(const f32x4*)(y1 + (size_t)row * DM + 4 * (F.lane + 64 * j));
                ss += (y[j][0] * y[j][0] + y[j][1] * y[j][1]) + (y[j][2] * y[j][2] + y[j][3] * y[j][3]); }
            const float rstd = 1.0f / sqrtf(wave_sum(ss) * (1.f / DM) + EPS);
#pragma unroll
            for (int j = 0; j < 4; ++j) { const int c = 4 * (F.lane + 64 * j); const f32x4 g = *(const f32x4*)(gpost + c); const f32x4 gt = *(const f32x4*)(modl_y + ((size_t)cond * 6 + gate_ch) * 1024 + c);
                x[j] = x[j] + gt * (y[j] * rstd * g); *(f32x4*)(xout + (size_t)row * DM + c) = x[j]; }
        }
        if (HAS_H) {
            float ss = 0.f;
#pragma unroll
            for (int j = 0; j < 4; ++j) ss += (x[j][0] * x[j][0] + x[j][1] * x[j][1]) + (x[j][2] * x[j][2] + x[j][3] * x[j][3]);
            const float rstd = 1.0f / sqrtf(wave_sum(ss) * (1.f / DM) + EPS);
#pragma unroll
            for (int j = 0; j < 4; ++j) { const int c = 4 * (F.lane + 64 * j); const f32x4 g = *(const f32x4*)(gpre + c);
                const f32x4 sc = *(const f32x4*)(modl_h + ((size_t)cond * 6 + scale_ch) * 1024 + c), sh = *(const f32x4*)(modl_h + ((size_t)cond * 6 + shift_ch) * 1024 + c);
                const f32x4 h = (x[j] * rstd * g) * (sc + 1.0f) + sh;
                *(u32x2*)(H + (size_t)row * DM + c) = (u32x2){cvtpk(h[0], h[1]), cvtpk(h[2], h[3])}; }
        }
    }
}

__device__ __forceinline__ void unpack8(const u32x4 w, float (&f)[8]) { f[0] = bflo(w.x); f[1] = bfhi(w.x); f[2] = bflo(w.y); f[3] = bfhi(w.y); f[4] = bflo(w.z); f[5] = bfhi(w.z); f[6] = bflo(w.w); f[7] = bfhi(w.w); }
__device__ __forceinline__ u32x4 pack8(const float (&f)[8]) { return (u32x4){cvtpk(f[0], f[1]), cvtpk(f[2], f[3]), cvtpk(f[4], f[5]), cvtpk(f[6], f[7])}; }
__device__ __forceinline__ void rope8(float (&x)[8], int lane, int t, const f32x2* tab) {
    const int j = lane & 7, which = j >> 2, jj = j & 3; const int pos = which ? (t & 63) : (t >> 6);
    const f32x2* tp = tab + pos * 16 + 8 * (jj & 1);
#pragma unroll
    for (int i = 0; i < 8; ++i) { const float pv = __shfl_xor(x[i], 2); const f32x2 cs = tp[i]; x[i] = (jj < 2) ? (x[i] * cs.x - pv * cs.y) : (x[i] * cs.x + pv * cs.y); }
}
__device__ __forceinline__ void even_post(const Frame& F, int e) {
    const int gw = F.bid * NWAVES + F.wave, NGW = F.G * NWAVES, lane = F.lane;
    const bf16_t* Z = (const bf16_t*)(F.ws + WS_Z);
    const f32x2* tab = (const f32x2*)(F.ws + WS_ROPE);
    const float* sgun = inp(I_SGUN) + e * 512; const float* qn = inp(I_QN) + e * 64; const float* kn = inp(I_KN) + e * 64;
    for (int row = gw; row < NTOK; row += NGW) {
        const bool smp = row >= NPR; const int b = smp ? (row - NPR) >> 10 : row >> 8, t = smp ? (row - NPR) & 1023 : row & 255;
        const bf16_t* z = Z + (size_t)row * EVEN_IN;
        const u32x4 wu = *(const u32x4*)(z + 8 * lane), wv = *(const u32x4*)(z + 512 + 8 * lane), wq = *(const u32x4*)(z + 1024 + 8 * lane), wk = *(const u32x4*)(z + 1536 + 8 * (lane & 31));
        float f[8];
        unpack8(wu, f);
#pragma unroll
        for (int i = 0; i < 8; ++i) f[i] = gelu_tanh(f[i]);
        *(u32x4*)((bf16_t*)(F.ws + WS_UG) + (size_t)row * 512 + 8 * lane) = pack8(f);
        unpack8(wv, f); float s = 0.f;
#pragma unroll
        for (int i = 0; i < 8; ++i) { f[i] = gelu_tanh(f[i]); s += f[i]; }
        const float mean = wave_sum(s) * (1.f / 512.f); float s2 = 0.f;
#pragma unroll
        for (int i = 0; i < 8; ++i) { f[i] -= mean; s2 += f[i] * f[i]; }
        { const float rstd = 1.0f / sqrtf(wave_sum(s2) * (1.f / 512.f) + EPS);
#pragma unroll
          for (int i = 0; i < 8; ++i) f[i] = f[i] * rstd * sgun[8 * lane + i]; }
        *(u32x4*)((bf16_t*)(F.ws + WS_VN) + (size_t)row * 512 + 8 * lane) = pack8(f);
        unpack8(wq, f); { float ss = 0.f;
#pragma unroll
          for (int i = 0; i < 8; ++i) ss += f[i] * f[i];
          ss += __shfl_xor(ss, 1); ss += __shfl_xor(ss, 2); ss += __shfl_xor(ss, 4);
          const float rstd = 1.0f / sqrtf(ss * (1.f / 64.f) + EPS);
#pragma unroll
          for (int i = 0; i < 8; ++i) f[i] = f[i] * rstd * qn[8 * (lane & 7) + i]; }
        if (smp) rope8(f, lane, t, tab);
#pragma unroll
        for (int i = 0; i < 8; ++i) f[i] *= C2;
        *(u32x4*)((bf16_t*)(F.ws + WS_QB) + (size_t)row * 512 + 8 * lane) = pack8(f);
        unpack8(wk, f);
        const bool isk = (lane & 31) < 16;
        { float ss = 0.f;
#pragma unroll
          for (int i = 0; i < 8; ++i) ss += f[i] * f[i];
          ss += __shfl_xor(ss, 1); ss += __shfl_xor(ss, 2); ss += __shfl_xor(ss, 4);
          const float rstd = 1.0f / sqrtf(ss * (1.f / 64.f) + EPS);
          if (isk) {
#pragma unroll
              for (int i = 0; i < 8; ++i) f[i] = f[i] * rstd * kn[8 * (lane & 7) + i]; } }
        float fo[8];
#pragma unroll
        for (int i = 0; i < 8; ++i) fo[i] = f[i];
        { float fr[8];
#pragma unroll
          for (int i = 0; i < 8; ++i) fr[i] = f[i];
          rope8(fr, lane, t, tab);
          if (smp && isk) {
#pragma unroll
              for (int i = 0; i < 8; ++i) f[i] = fr[i]; } }
        if (lane < 32) {
            const int cc = 8 * (lane & 15);
            if (!smp) {
                float* od = F.out + (isk ? OUT_AK : OUT_AV) + ((size_t)(b * 2 + e) * 256 + t) * 128 + cc;
                *(f32x4*)od = (f32x4){fo[0], fo[1], fo[2], fo[3]}; *(f32x4*)(od + 4) = (f32x4){fo[4], fo[5], fo[6], fo[7]};
                *(u32x4*)((bf16_t*)(F.ws + (isk ? WS_KP : WS_VP)) + (size_t)row * 128 + cc) = pack8(f);
            } else {
                *(u32x4*)((bf16_t*)(F.ws + (isk ? WS_KS : WS_VS)) + ((size_t)(e * 4 + b) * 1280 + t) * 128 + cc) = pack8(f);
            }
        }
    }
}

__device__ __forceinline__ void gmlp_item(const Frame& F, int e, int item) {
    const int chunk = item >> 2, g = item & 3, row0 = chunk * 128, tid = F.tid, lane = F.lane, w = F.wave;
    LAS bf16_t* Vt = (LAS bf16_t*)F.lds;
    const bf16_t* VN = (const bf16_t*)(F.ws + WS_VN); const bf16_t* UG = (const bf16_t*)(F.ws + WS_UG); bf16_t* AO = (bf16_t*)(F.ws + WS_AO);
    __syncthreads();
#pragma unroll
    for (int i = 0; i < 4; ++i) { const int p = tid + 512 * i, q = p >> 4, cb = (p & 15) * 8;
        const u32x4 v = *(const u32x4*)(VN + (size_t)(row0 + q) * 512 + g * 128 + cb);
        Vt[(cb + 0) * 136 + q] = (bf16_t)(v.x & 0xffff); Vt[(cb + 1) * 136 + q] = (bf16_t)(v.x >> 16);
        Vt[(cb + 2) * 136 + q] = (bf16_t)(v.y & 0xffff); Vt[(cb + 3) * 136 + q] = (bf16_t)(v.y >> 16);
        Vt[(cb + 4) * 136 + q] = (bf16_t)(v.z & 0xffff); Vt[(cb + 5) * 136 + q] = (bf16_t)(v.z >> 16);
        Vt[(cb + 6) * 136 + q] = (bf16_t)(v.w & 0xffff); Vt[(cb + 7) * 136 + q] = (bf16_t)(v.w >> 16); }
    __syncthreads();
    const bf16_t* Wg = (const bf16_t*)(F.ws + WS_SGUW) + ((size_t)(e * 4 + g) * 128 + 16 * w + (lane & 15)) * 128 + 8 * (lane >> 4);
    bf16x8 wf[4];
#pragma unroll
    for (int ks = 0; ks < 4; ++ks) wf[ks] = *(const bf16x8*)(Wg + 32 * ks);
    f32x4 acc[8];
#pragma unroll
    for (int nb = 0; nb < 8; ++nb) { acc[nb] = (f32x4){0.f, 0.f, 0.f, 0.f};
#pragma unroll
        for (int ks = 0; ks < 4; ++ks) { const bf16x8 vf = *(const LAS bf16x8*)(Vt + (16 * nb + (lane & 15)) * 136 + 32 * ks + 8 * (lane >> 4));
            acc[nb] = __builtin_amdgcn_mfma_f32_16x16x32_bf16(vf, wf[ks], acc[nb], 0, 0, 0); } }
    const int p = 16 * w + (lane & 15); const float bias = inp(I_SGUB)[(e * 4 + g) * 128 + p];
#pragma unroll
    for (int nb = 0; nb < 8; ++nb) { const int c = 16 * nb + 4 * (lane >> 4);
        const u32x2 uu = *(const u32x2*)(UG + (size_t)(row0 + p) * 512 + g * 128 + c);
        const float o0 = bflo(uu.x) * (acc[nb][0] + bias), o1 = bfhi(uu.x) * (acc[nb][1] + bias), o2 = bflo(uu.y) * (acc[nb][2] + bias), o3 = bfhi(uu.y) * (acc[nb][3] + bias);
        *(u32x2*)(AO + (size_t)(row0 + p) * 1024 + g * 128 + c) = (u32x2){cvtpk(o0, o1), cvtpk(o2, o3)}; }
}

struct SrcPlain { const bf16_t* k; const bf16_t* v; int kp, vp;
    __device__ __forceinline__ void tile(int t, const bf16_t*& kb, int& kp_, const bf16_t*& vb, int& vp_) const { kb = k + (size_t)t * 64 * kp; vb = v + (size_t)t * 64 * vp; kp_ = kp; vp_ = vp; } };
struct SrcNa { const bf16_t* ck; const bf16_t* cv; const bf16_t* zk; const bf16_t* zv; int lo;
    __device__ __forceinline__ void tile(int t, const bf16_t*& kb, int& kp_, const bf16_t*& vb, int& vp_) const {
        if (t < 4) { kb = ck + (size_t)t * 64 * 1024; vb = cv + (size_t)t * 64 * 1024; kp_ = 1024; vp_ = 1024; }
        else { const size_t r = (size_t)(lo + t - 4) * 64 * ODD_IN; kb = zk + r; vb = zv + r; kp_ = ODD_IN; vp_ = ODD_IN; } } };

__device__ __forceinline__ void even_sample_unit(const Frame& F, int e, int item) {
    const bf16_t* QB = (const bf16_t*)(F.ws + WS_QB); bf16_t* AO = (bf16_t*)(F.ws + WS_AO);
    const int b = item >> 5, h = (item >> 2) & 7, qb = item & 3, g = h >> 2;
    const size_t qrow = (size_t)NPR + b * 1024 + qb * 256 + F.wave * 32;
    SrcPlain src{(const bf16_t*)(F.ws + WS_KS) + (size_t)(e * 4 + b) * 1280 * 128 + g * 64, (const bf16_t*)(F.ws + WS_VS) + (size_t)(e * 4 + b) * 1280 * 128 + g * 64, 128, 128};
    att::unit(F.tid, QB + qrow * 512 + h * 64, 512, AO + qrow * 1024 + 512 + h * 64, 1024, 20, src, att::NoMask(), F.lds);
}
__device__ __forceinline__ void even_prompt_unit(const Frame& F, int e, int u) {
    const bf16_t* QB = (const bf16_t*)(F.ws + WS_QB); bf16_t* AO = (bf16_t*)(F.ws + WS_AO);
    const int b = u >> 3, h = u & 7, g = h >> 2;
    const size_t qrow = (size_t)b * 256 + F.wave * 32;
    SrcPlain src{(const bf16_t*)(F.ws + WS_KP) + (size_t)b * 256 * 128 + g * 64, (const bf16_t*)(F.ws + WS_VP) + (size_t)b * 256 * 128 + g * 64, 128, 128};
    att::unit(F.tid, QB + qrow * 512 + h * 64, 512, AO + qrow * 1024 + 512 + h * 64, 1024, 4, src, att::NoMask(), F.lds);
}
__device__ __forceinline__ void even_mix(const Frame& F, int e) {
    if (F.G == 256) {
        if (F.bid < 128) even_sample_unit(F, e, F.bid);
        else { const int k = F.bid - 128; even_prompt_unit(F, e, k); gmlp_item(F, e, 2 * k); gmlp_item(F, e, 2 * k + 1); }
        return;
    }
    for (int it = F.bid; it < 512; it += F.G) {
        if (it < 128) even_sample_unit(F, e, it);
        else if (it < 256) even_prompt_unit(F, e, it - 128);
        else gmlp_item(F, e, it - 256);
    }
}
__device__ __forceinline__ void odd_mix(const Frame& F, int o) {
    const bf16_t* Z = (const bf16_t*)(F.ws + WS_Z); bf16_t* AO = (bf16_t*)(F.ws + WS_AO);
    for (int it = F.bid; it < 512; it += F.G) {
        if (it < 256) {
            const int b = it >> 6, h = (it >> 2) & 15, u = it & 3;
            const int lo = (u == 0) ? 0 : (u == 1) ? 0 : (u == 2) ? 4 : 8, nwin = (u == 0 || u == 3) ? 8 : 12;
            __syncthreads();
            LAS float* rp = (LAS float*)(F.lds + att::LDS_RPB);
            if (F.tid < 465) rp[F.tid] = inp(I_RPB)[((size_t)o * 16 + h) * 465 + F.tid] * LOG2E;
            __syncthreads();
            const size_t qrow = (size_t)NPR + b * 1024 + u * 256 + F.wave * 32;
            const bf16_t* zb = Z + (size_t)(NPR + b * 1024) * ODD_IN + h * 64;
            SrcNa src{(const bf16_t*)(F.ws + WS_CK) + (size_t)(o * 4 + b) * 256 * 1024 + h * 64, (const bf16_t*)(F.ws + WS_CV) + (size_t)(o * 4 + b) * 256 * 1024 + h * 64, zb + 1024, zb + 2048, lo};
            att::NaMask mk{rp, 4 * u + (F.wave >> 1), 32 * (F.wave & 1), lo};
            att::unit(F.tid, Z + qrow * ODD_IN + h * 64, ODD_IN, AO + qrow * 1024 + h * 64, 1024, 4 + nwin, src, mk, F.lds);
        } else {
            const int u = it - 256, b = u >> 4, h = u & 15;
            const size_t qrow = (size_t)b * 256 + F.wave * 32;
            const bf16_t* zb = Z + (size_t)b * 256 * ODD_IN + h * 64;
            SrcPlain src{zb + 1024, zb + 2048, ODD_IN, ODD_IN};
            att::unit(F.tid, Z + qrow * ODD_IN + h * 64, ODD_IN, AO + qrow * 1024 + h * 64, 1024, 4, src, att::NoMask(), F.lds);
        }
    }
}

constexpr int N_PHASES = 2 + 8 * DEPTH;
__device__ __forceinline__ bool phase_empty(int ph) { if (ph < 2) return false; const int l = (ph - 2) >> 3, s = (ph - 2) & 7; return (l & 1) && s == 1; }

__global__ void __launch_bounds__(NWAVES * 64, 2) mega_fwd(Args args) {
    extern __shared__ __attribute__((aligned(16))) unsigned char lds_raw[];
    Frame F;
    F.lds = (LAS unsigned char*)lds_raw; F.tid = threadIdx.x; F.lane = F.tid & 63; F.wave = __builtin_amdgcn_readfirstlane(F.tid >> 6);
    F.G = gridDim.x; F.bid = blockIdx.x; F.ws = args.ws; F.out = args.out;
    for (int u = F.tid; u < (LDS_BYTES - LDSCTL_OFF) / 4; u += NWAVES * 64) ((LAS unsigned*)(F.lds + LDSCTL_OFF))[u] = 0u;
    __syncthreads();
    XcdBarrier bar; bar.bar = (unsigned*)(F.ws + WS_CTL) + CW_BAR; bar.x = 0; bar.st = nullptr;
    if (!MK_PER_PHASE) bar = xcd_barrier_post((unsigned*)(F.ws + WS_CTL) + CW_BAR, (volatile LAS unsigned*)(F.lds + MISC_OFF) + 8);
    bool first = true;
    const Frame F0 = F;
    for (int ph = args.ph_lo; ph < args.ph_hi; ++ph) {
        if (phase_empty(ph)) continue;
        if (!first) { if (!MK_PER_PHASE) xcd_barrier(bar); }
        first = false;
        { int t_ = F0.tid; asm volatile("" : "+v"(t_)); F.tid = t_; F.lane = t_ & 63; F.wave = __builtin_amdgcn_readfirstlane(t_ >> 6);
          unsigned char* w_ = F0.ws; asm volatile("" : "+s"(w_)); F.ws = w_; float* o_ = F0.out; asm volatile("" : "+s"(o_)); F.out = o_;
          int g_ = F0.G, b_ = F0.bid; asm volatile("" : "+s"(g_), "+s"(b_)); F.G = g_; F.bid = b_; }
        if (ph == 0) {
#ifndef DIS_P0
            p0_prologue(F);
#endif
            continue; }
        float* X = F.out + OUT_X;
        const float* MOD = (const float*)(F.ws + WS_MOD);
        bf16_t* H = (bf16_t*)(F.ws + WS_H);
        float* Y0 = (float*)(F.ws + WS_Y0); float* Y1 = Y0 + (size_t)NTOK * DM;
        if (ph == 1) {
            norm_phase<false, true>(F, inp(I_XP), inp(I_XS), nullptr, nullptr, nullptr, 0, nullptr, inp(I_NMPRE), MOD, 1, 0, MOD, H);
            continue; }
        const int l = (ph - 2) >> 3, s = (ph - 2) & 7, eo = l >> 1; const bool odd = l & 1;
        const float* modl = MOD + (size_t)l * 5 * 6144;
        switch (s) {
#ifndef DIS_G0
        case 0: {
            pg8::Order S;
            if (!odd) { pg8::Gemm g{H, (const bf16_t*)(F.ws + WS_WINE) + (size_t)eo * EVEN_IN * DM, DM, DM, DM}; S.init(NTOK, EVEN_IN, 1, F.G, F.bid);
                pg8::EpiBf16 E{(bf16_t*)(F.ws + WS_Z), EVEN_IN, 0, 1.f, nullptr, nullptr}; pg8::gemm_phase(F.lds, F.tid, g, S, E); }
            else { pg8::Gemm g{H, (const bf16_t*)(F.ws + WS_WINO) + (size_t)eo * ODD_IN * DM, DM, DM, DM}; S.init(NTOK, ODD_IN, 1, F.G, F.bid);
                pg8::EpiBf16 E{(bf16_t*)(F.ws + WS_Z), ODD_IN, 1024, C2, F.out + OUT_NK + (size_t)eo * 256 * 1024, F.out + OUT_NV + (size_t)eo * 256 * 1024}; pg8::gemm_phase(F.lds, F.tid, g, S, E); }
        } break;
#endif
#ifndef DIS_POST
        case 1: even_post(F, eo); break;
#endif
#ifndef DIS_MIX
        case 2: if (!odd) {
#ifndef DIS_EMIX
            even_mix(F, eo);
#endif
            } else {
#ifndef DIS_OMIX
            odd_mix(F, eo);
#endif
            } break;
#endif
#ifndef DIS_G3
        case 3: {
            pg8::Order S; S.init(NTOK, DM, 2, F.G, F.bid);
            pg8::Gemm g{(const bf16_t*)(F.ws + WS_AO), (const bf16_t*)(F.ws + (odd ? WS_WOUTO : WS_WOUTE)) + (size_t)eo * DM * DM, DM, DM, DM / 2};
            pg8::EpiF32 E{Y0, DM, (size_t)NTOK * DM}; pg8::gemm_phase(F.lds, F.tid, g, S, E);
        } break;
#endif
#ifndef DIS_NORM
        case 4:
            norm_phase<true, true>(F, l == 0 ? inp(I_XP) : X, l == 0 ? inp(I_XS) : X + (size_t)NPR * DM, Y0, Y1, inp(I_NMPOST) + l * DM, 2, X, inp(I_NFPRE) + l * DM, modl, 4, 3, modl, H);
            break;
#endif
#ifndef DIS_G5
        case 5: {
            pg8::Order S; S.init(NTOK, 2 * DFF, 1, F.G, F.bid);
            pg8::Gemm g{H, (const bf16_t*)(F.ws + WS_WFI) + (size_t)l * 2 * DFF * DM, DM, DM, DM};
            pg8::EpiSwiglu E{(bf16_t*)(F.ws + WS_ACT), DFF}; pg8::gemm_phase(F.lds, F.tid, g, S, E);
        } break;
#endif
#ifndef DIS_G6
        case 6: {
            pg8::Order S; S.init(NTOK, DM, 2, F.G, F.bid);
            pg8::Gemm g{(const bf16_t*)(F.ws + WS_ACT), (const bf16_t*)(F.ws + WS_WFO) + (size_t)l * DM * DFF, DFF, DFF, DFF / 2};
            pg8::EpiF32 E{Y0, DM, (size_t)NTOK * DM}; pg8::gemm_phase(F.lds, F.tid, g, S, E);
        } break;
#endif
#ifndef DIS_NORM
        case 7:
            if (l < DEPTH - 1) norm_phase<true, true>(F, X, X + (size_t)NPR * DM, Y0, Y1, inp(I_NFPOST) + l * DM, 5, X, inp(I_NMPRE) + (l + 1) * DM, modl + 5 * 6144, 1, 0, modl, H);
            else norm_phase<true, false>(F, X, X + (size_t)NPR * DM, Y0, Y1, inp(I_NFPOST) + l * DM, 5, X, nullptr, modl, 1, 0, modl, H);
            break;
#endif
        default: break;
        }
    }
}

extern "C" void kernel_launch(void* const* d_in, const int* in_sizes, int n_in, void* d_out, int out_size, void* d_ws, size_t ws_size, hipStream_t stream) {
    static int grid = 0;
    if (grid == 0) {
        if (n_in != 26 || ws_size < WS_END) { fprintf(stderr, "kernel_launch: unexpected n_in %d / ws %zu\n", n_in, ws_size); grid = -1; return; }
        int dev = 0, cus = 0, per_cu = 0;
        if (hipGetDevice(&dev) != hipSuccess || hipDeviceGetAttribute(&cus, hipDeviceAttributeMultiprocessorCount, dev) != hipSuccess) { grid = -1; return; }
        if (hipFuncSetAttribute((const void*)mega_fwd, hipFuncAttributeMaxDynamicSharedMemorySize, LDS_BYTES) != hipSuccess) { fprintf(stderr, "kernel_launch: hipFuncSetAttribute failed\n"); grid = -1; return; }
        if (hipOccupancyMaxActiveBlocksPerMultiprocessor(&per_cu, (const void*)mega_fwd, NWAVES * 64, LDS_BYTES) != hipSuccess || per_cu < 1) { fprintf(stderr, "kernel_launch: occupancy query says %d\n", per_cu); (void)hipGetLastError(); grid = -1; return; }
        grid = cus;
    }
    if (grid < 0) return;
    (void)hipMemsetAsync((char*)d_ws + WS_CTL, 0, CTL_ZERO_BYTES, stream);
    Args a{};
    for (int i = 0; i < 26; ++i) a.in[i] = (const float*)d_in[i];
    a.out = (float*)d_out; a.ws = (unsigned char*)d_ws;
#if MK_PER_PHASE
    for (int ph = 0; ph < N_PHASES; ++ph) {
        const int l = (ph - 2) >> 3, s = (ph - 2) & 7; if (ph >= 2 && (l & 1) && s == 1) continue;
        a.ph_lo = ph; a.ph_hi = ph + 1;
        hipLaunchKernelGGL(mega_fwd, dim3(grid), dim3(NWAVES * 64), LDS_BYTES, stream, a);
    }
#else
    a.ph_lo = 0; a.ph_hi = N_PHASES;
    void* kargs[] = {&a};
    hipError_t e = hipLaunchCooperativeKernel((const void*)mega_fwd, dim3(grid), dim3(NWAVES * 64), kargs, LDS_BYTES, stream);
    if (e != hipSuccess) fprintf(stderr, "kernel_launch: cooperative launch failed: %s (grid %d)\n", hipGetErrorString(e), grid);
#endif
}
```
